# Optimizing an MI355X kernel written in HIP

```python
import jax, jax.numpy as jnp
from jax import lax
import numpy as np

D_MODEL = 1024
BATCH = 4
SEQ = 8192
DEPTH = 1

CHUNK = 64
HEAD_DIM = 64
N_HEADS_A = 8
N_HEADS_B = 8
D_A = N_HEADS_A * HEAD_DIM
D_B = N_HEADS_B * HEAD_DIM
D_MIX = D_A + D_B
N_LEFT_CHUNKS = 8
BAND_CHUNKS = N_LEFT_CHUNKS + 1
REL_CLIP = 128
Q_BLOCK = 128
D_FF = 2816
CONV_WIDTH = 3
LN_EPS = 1e-5
DEEPNORM_ALPHA = (2.0 * DEPTH) ** 0.25
DEEPNORM_BETA = (8.0 * DEPTH) ** -0.25
PROJ_COLS = 3 * D_A + N_HEADS_A + 3 * D_B
SPLITS = (D_A, 2 * D_A, 3 * D_A, 3 * D_A + N_HEADS_A,
          3 * D_A + N_HEADS_A + D_B, 3 * D_A + N_HEADS_A + 2 * D_B)

kernel_name = "hymba_style_fox_chunkband_convffn_deepnorm"


def layer_norm(x, g, b):
    xf = x.astype(jnp.float32)
    mu = jnp.mean(xf, axis=-1, keepdims=True)
    var = jnp.mean(jnp.square(xf - mu), axis=-1, keepdims=True)
    y = (xf - mu) * lax.rsqrt(var + LN_EPS)
    return (y * g.astype(jnp.float32) + b.astype(jnp.float32)).astype(x.dtype)


def split_heads(t, n_heads):
    b, s, _ = t.shape
    return t.reshape(b, s, n_heads, HEAD_DIM).transpose(0, 2, 1, 3)


def forgetting_attention(q, k, v, log_f):
    b, h, s, d = q.shape
    n_blk = s // Q_BLOCK
    cum = jnp.cumsum(log_f.astype(jnp.float32), axis=-1)
    q_blocks = q.reshape(b, h, n_blk, Q_BLOCK, d).transpose(2, 0, 1, 3, 4)
    c_blocks = cum.reshape(b, h, n_blk, Q_BLOCK).transpose(2, 0, 1, 3)
    starts = jnp.arange(n_blk, dtype=jnp.int32) * Q_BLOCK
    k_pos = jnp.arange(s, dtype=jnp.int32)
    scale = d ** -0.5

    def one_block(args):
        qb, cb, start = args
        logits = jnp.einsum('bhqd,bhkd->bhqk', qb, k).astype(jnp.float32) * scale
        logits = logits + cb[..., :, None] - cum[..., None, :]
        q_pos = start + jnp.arange(Q_BLOCK, dtype=jnp.int32)
        causal = k_pos[None, :] <= q_pos[:, None]
        logits = jnp.where(causal, logits, -jnp.inf)
        p = jax.nn.softmax(logits, axis=-1)
        return jnp.einsum('bhqk,bhkd->bhqd', p.astype(v.dtype), v)

    out = lax.map(one_block, (q_blocks, c_blocks, starts))
    return out.transpose(1, 2, 0, 3, 4).reshape(b, h, s, d)


def chunked_band_attention(q, k, v, rel_bias):
    b, h, s, d = q.shape
    n_c = s // CHUNK
    band = BAND_CHUNKS * CHUNK
    qc = q.reshape(b, h, n_c, CHUNK, d)
    pad = ((0, 0), (0, 0), (N_LEFT_CHUNKS, 0), (0, 0), (0, 0))
    kp = jnp.pad(k.reshape(b, h, n_c, CHUNK, d), pad)
    vp = jnp.pad(v.reshape(b, h, n_c, CHUNK, d), pad)
    band_idx = np.arange(n_c)[:, None] + np.arange(BAND_CHUNKS)[None, :]
    k_band = kp[:, :, band_idx].reshape(b, h, n_c, band, d)
    v_band = vp[:, :, band_idx].reshape(b, h, n_c, band, d)
    dist = (N_LEFT_CHUNKS * CHUNK + np.arange(CHUNK)[:, None]) - np.arange(band)[None, :]
    rel_idx = np.clip(dist, -REL_CLIP, REL_CLIP) + REL_CLIP
    bias = rel_bias.astype(jnp.float32)[:, rel_idx]
    valid = (np.arange(n_c)[:, None] + np.arange(band)[None, :] // CHUNK) >= N_LEFT_CHUNKS
    logits = jnp.einsum('bhcqd,bhckd->bhcqk', qc, k_band).astype(jnp.float32) * (d ** -0.5)
    logits = logits + bias[None, :, None, :, :]
    logits = jnp.where(valid[None, None, :, None, :], logits, -jnp.inf)
    p = jax.nn.softmax(logits, axis=-1)
    out = jnp.einsum('bhcqk,bhckd->bhcqd', p.astype(v.dtype), v_band)
    return out.reshape(b, h, s, d)


def token_mixer(x, w_in, b_forget, rel_bias, w_out):
    b, s, _ = x.shape
    proj = x @ w_in
    q_a, k_a, v_a, f_a, q_b, k_b, v_b = jnp.split(proj, SPLITS, axis=-1)
    log_f = jax.nn.log_sigmoid((f_a + b_forget).astype(jnp.float32)).transpose(0, 2, 1)
    y_a = forgetting_attention(split_heads(q_a, N_HEADS_A), split_heads(k_a, N_HEADS_A),
                               split_heads(v_a, N_HEADS_A), log_f)
    y_b = chunked_band_attention(split_heads(q_b, N_HEADS_B), split_heads(k_b, N_HEADS_B),
                                 split_heads(v_b, N_HEADS_B), rel_bias)
    y = jnp.concatenate([y_a, y_b], axis=1)
    y = y.transpose(0, 2, 1, 3).reshape(b, s, D_MIX)
    return y @ w_out


def conv_ffn(x, w_up, conv_w, conv_b, w_down):
    s = x.shape[1]
    u = x @ w_up
    u_pad = jnp.pad(u, ((0, 0), (CONV_WIDTH - 1, 0), (0, 0)))
    u = sum(u_pad[:, j:j + s, :] * conv_w[j] for j in range(CONV_WIDTH)) + conv_b
    value, gate = jnp.split(u, 2, axis=-1)
    return (value * jax.nn.gelu(gate)) @ w_down


def setup_inputs(seed: int = 0) -> dict:
    key = jax.random.key(seed)
    ks = jax.random.split(key, 16)
    f32 = jnp.float32
    x = jax.random.normal(ks[0], (BATCH, SEQ, D_MODEL), f32)
    col_scale = np.ones((PROJ_COLS,), np.float32)
    col_scale[2 * D_A:3 * D_A] = DEEPNORM_BETA
    col_scale[SPLITS[5]:] = DEEPNORM_BETA
    w_in = jax.random.normal(ks[1], (DEPTH, D_MODEL, PROJ_COLS), f32) * (D_MODEL ** -0.5) * jnp.asarray(col_scale)
    b_forget = jax.random.uniform(ks[2], (DEPTH, N_HEADS_A), f32, 2.0, 5.0)
    rel_bias = jax.random.normal(ks[3], (DEPTH, N_HEADS_B, 2 * REL_CLIP + 1), f32) * 0.5
    w_out = jax.random.normal(ks[4], (DEPTH, D_MIX, D_MODEL), f32) * (D_MIX ** -0.5) * DEEPNORM_BETA
    ln1_g = 1.0 + 0.05 * jax.random.normal(ks[5], (DEPTH, D_MODEL), f32)
    ln1_b = 0.02 * jax.random.normal(ks[6], (DEPTH, D_MODEL), f32)
    w_up = jax.random.normal(ks[7], (DEPTH, D_MODEL, 2 * D_FF), f32) * (D_MODEL ** -0.5)
    conv_w = jax.random.normal(ks[8], (DEPTH, CONV_WIDTH, 2 * D_FF), f32) * (CONV_WIDTH ** -0.5)
    conv_b = 0.02 * jax.random.normal(ks[9], (DEPTH, 2 * D_FF), f32)
    w_down = jax.random.normal(ks[10], (DEPTH, D_FF, D_MODEL), f32) * (D_FF ** -0.5) * DEEPNORM_BETA
    ln2_g = 1.0 + 0.05 * jax.random.normal(ks[11], (DEPTH, D_MODEL), f32)
    ln2_b = 0.02 * jax.random.normal(ks[12], (DEPTH, D_MODEL), f32)
    return {"x": x, "w_in": w_in, "b_forget": b_forget, "rel_bias": rel_bias, "w_out": w_out,
            "ln1_g": ln1_g, "ln1_b": ln1_b, "w_up": w_up, "conv_w": conv_w, "conv_b": conv_b,
            "w_down": w_down, "ln2_g": ln2_g, "ln2_b": ln2_b}


def reference(x, w_in, b_forget, rel_bias, w_out, ln1_g, ln1_b, w_up, conv_w, conv_b,
              w_down, ln2_g, ln2_b):
    for l in range(DEPTH):
        mix = token_mixer(x, w_in[l], b_forget[l], rel_bias[l], w_out[l])
        x = layer_norm(DEEPNORM_ALPHA * x + mix, ln1_g[l], ln1_b[l])
        ffn = conv_ffn(x, w_up[l], conv_w[l], conv_b[l], w_down[l])
        x = layer_norm(DEEPNORM_ALPHA * x + ffn, ln2_g[l], ln2_b[l])
    return x
```

```cpp
#include <hip/hip_runtime.h>
#include <cstdio>
#include <cstdint>
namespace pg8 {
#define PG8_LAS __attribute__((address_space(3)))
typedef unsigned short bf16_t;
typedef short bf16x8 __attribute__((ext_vector_type(8)));
typedef float f32x4 __attribute__((ext_vector_type(4)));
typedef unsigned u32x4 __attribute__((ext_vector_type(4)));
constexpr int BM = 256, BK = 64, HALF = 128, HTB = HALF * BK * 2  , STAGE_BYTES = 8 * HTB, NXCD = 8, WGM = 8;

__host__ __device__ __forceinline__ int lds_byte(int r, int c) { const int st = (r >> 4) * 2 + (c >> 5), rr = r & 15, cc = c & 31, ob = rr * 64 + cc * 2; return st * 1024 + (ob ^ (((ob >> 9) & 1) << 5)); }
__host__ __device__ __forceinline__ void stage_rc(int b, int& R, int& C) { const int st = b / 1024, sb = b % 1024, swz = sb ^ (((sb >> 9) & 1) << 5); R = (st >> 1) * 16 + swz / 64; C = (st & 1) * 32 + (swz % 64) / 2; }
__host__ __device__ __forceinline__ int perm32(int rho) { const int n = rho >> 4, i = rho & 15; return 8 * (i >> 2) + 4 * n + (i & 3); }

struct Unit { int pm, pn; };
struct Gemm { const bf16_t* A; const bf16_t* Bt; int M, N, K; };

struct StaticOrder {
    int nM, nN, nwg, G, c;
    __host__ __device__ void init(int M, int N, int G_, int c_) { nM = M / BM; nN = N / BM; nwg = nM * nN; G = G_; c = c_; }
    __host__ __device__ bool next(int i, Unit& u) const {
        const long L = (long)i * G + c; if (L >= nwg) return false;
        int wgid = (int)L; { const int q = nwg / NXCD, r = nwg % NXCD, xcd = wgid % NXCD, off = wgid / NXCD; wgid = (xcd < r ? xcd * (q + 1) : r * (q + 1) + (xcd - r) * q) + off; }
        const int nig = WGM * nN, gid = wgid / nig, fm = gid * WGM, gsz = (nM - fm) < WGM ? (nM - fm) : WGM;
        u.pm = fm + ((wgid % nig) % gsz); u.pn = (wgid % nig) / gsz; return true;
    }
    __device__ __forceinline__ void a_ready(const Unit&) const {}
    __device__ __forceinline__ void done(const Unit&) const {}
};

__device__ __forceinline__ unsigned cvt_pk_bf16(float lo, float hi) { unsigned r; asm volatile("v_cvt_pk_bf16_f32 %0, %1, %2" : "=v"(r) : "v"(lo), "v"(hi)); return r; }
typedef float f32x2 __attribute__((ext_vector_type(2)));
__device__ __forceinline__ f32x2 gelu_pk(f32x2 v) {
    const f32x2 av = __builtin_elementwise_abs(v), d = av * 0.2316418882f + 1.0f;
    f32x2 t; t.x = __builtin_amdgcn_rcpf(d.x); t.y = __builtin_amdgcn_rcpf(d.y);
    f32x2 q = t * 0.5307027145f + (-0.7265760135f); q = q * t + 0.7107068705f; q = q * t + (-0.142248368f); q = q * t + 0.127414796f; q = q * t;
    const f32x2 s = (v * v) * (-0.72134752044f);
    f32x2 e; e.x = __builtin_amdgcn_exp2f(s.x); e.y = __builtin_amdgcn_exp2f(s.y);
    const f32x2 m = v * (q * e), r = v - m;
    f32x2 o; o.x = v.x < 0.f ? m.x : r.x; o.y = v.y < 0.f ? m.y : r.y; return o;
}

template <int ACT  > struct EpiBf16 {
    static constexpr bool PERM = true, AFTER_DRAIN = false; static_assert(ACT == 0 || ACT == 1, "EpiBf16: ACT is 0 (none) or 1 (gelu_pk)");
    bf16_t* O; int ldc; const float* bias; int split_cols; size_t split_stride; float scale0;
    __device__ __forceinline__ void operator()(const f32x4 (&acc)[2][2][4][2], const Unit& u, int wr, int wc, int fr, int fq) const {
        const int row0 = u.pm * BM + wr * 64 + fr; int colt = u.pn * BM; bf16_t* base = O;
        float sc = 1.f; if (split_cols) { const int t = colt / split_cols; base += (size_t)t * split_stride; colt -= t * split_cols; if (t == 0 || t == 3) sc = scale0; }
        const int col0 = colt + wc * 32 + 8 * fq, bcol0 = u.pn * BM + wc * 32 + 8 * fq;
        f32x4 bv[2][2];
#pragma unroll
        for (int bj = 0; bj < 2; ++bj)
#pragma unroll
            for (int n = 0; n < 2; ++n) bv[bj][n] = bias ? *(const f32x4*)(bias + bcol0 + bj * HALF + 4 * n) : (f32x4){0.f, 0.f, 0.f, 0.f};
#pragma unroll
        for (int ai = 0; ai < 2; ++ai)
#pragma unroll
            for (int m = 0; m < 4; ++m) { bf16_t* rowp = base + (size_t)(row0 + ai * HALF + m * 16) * ldc + col0;
#pragma unroll
                for (int bj = 0; bj < 2; ++bj) { f32x4 v0 = acc[ai][bj][m][0] + bv[bj][0], v1 = acc[ai][bj][m][1] + bv[bj][1];
                    if (ACT == 1) { f32x2 a = gelu_pk((f32x2){v0[0], v0[1]}), b = gelu_pk((f32x2){v0[2], v0[3]}), c = gelu_pk((f32x2){v1[0], v1[1]}), d = gelu_pk((f32x2){v1[2], v1[3]});
                        v0 = (f32x4){a.x, a.y, b.x, b.y}; v1 = (f32x4){c.x, c.y, d.x, d.y}; }
                    v0 = v0 * sc; v1 = v1 * sc; u32x4 w; w.x = cvt_pk_bf16(v0[0], v0[1]); w.y = cvt_pk_bf16(v0[2], v0[3]); w.z = cvt_pk_bf16(v1[0], v1[1]); w.w = cvt_pk_bf16(v1[2], v1[3]);
                    *(u32x4*)(rowp + bj * HALF) = w; } }
    }
};
template <class Epi, class Sched, bool ALIGN_EPI = false, bool SP2 = false>
__device__ __forceinline__ void gemm_phase(PG8_LAS unsigned char* lds, const Gemm g, const Sched& S, const Epi& E) {
    int tid_ = threadIdx.x; asm volatile("" : "+v"(tid_));
    const int tid = tid_, wid = __builtin_amdgcn_readfirstlane(tid >> 6), lane = tid & 63, wr = wid >> 2, wc = wid & 3, fr = lane & 15, fq = lane >> 4;
    const int K = g.K, nt = K / BK;
    unsigned voffA[2], voffB[2];
#pragma unroll
    for (int i = 0; i < 2; ++i) { int R, C; stage_rc(tid * 16 + i * 8192, R, C); const int Rb = Epi::PERM ? ((R & ~31) + perm32(R & 31)) : R;
        voffA[i] = (unsigned)(R * K + C) * 2u; voffB[i] = (unsigned)(Rb * K + C) * 2u; }
    const size_t kstep = (size_t)(BK * 2);
    const size_t hstep = (size_t)HALF * K * 2;
    const size_t tstep = 2 * hstep;
    const unsigned ldsw = (unsigned)wid * 1024u;
    const int aoff = lds_byte(wr * 64 + fr, fq * 8), boff = lds_byte(wc * 32 + fr, fq * 8);
#define PG8_SA(b, h) (((b) * 2 + (h)) * HTB)
#define PG8_SB(b, h) ((4 + (b) * 2 + (h)) * HTB)
#define PG8_STAGE(bufoff, gbase, voff) do { _Pragma("unroll") for (int _i = 0; _i < 2; ++_i) \
        __builtin_amdgcn_global_load_lds((const unsigned*)((const char*)(gbase) + (voff)[_i]), (PG8_LAS unsigned*)(lds + (bufoff) + ldsw + _i * 8192), 16, 0, 0); } while (0)
#define PG8_LDA(dst, b, h) do { _Pragma("unroll") for (int m = 0; m < 4; ++m) _Pragma("unroll") for (int k = 0; k < 2; ++k) dst[m][k] = *(const PG8_LAS bf16x8*)(lds + PG8_SA(b, h) + aoff + m * 2048 + k * 1024); } while (0)
#define PG8_LDB(dst, b, h) do { _Pragma("unroll") for (int n = 0; n < 2; ++n) _Pragma("unroll") for (int k = 0; k < 2; ++k) dst[n][k] = *(const PG8_LAS bf16x8*)(lds + PG8_SB(b, h) + boff + n * 2048 + k * 1024); } while (0)
#define PG8_MMA(ai, bj, At, Bt) do { __builtin_amdgcn_s_setprio(1); _Pragma("unroll") for (int m = 0; m < 4; ++m) _Pragma("unroll") for (int n = 0; n < 2; ++n) _Pragma("unroll") for (int k = 0; k < 2; ++k) \
        acc[ai][bj][m][n] = __builtin_amdgcn_mfma_f32_16x16x32_bf16(Bt[n][k], At[m][k], acc[ai][bj][m][n], 0, 0, 0); __builtin_amdgcn_s_setprio(0); } while (0)
#define PG8_WAIT_V(n) asm volatile("s_waitcnt vmcnt(" #n ")" ::: "memory")
#define PG8_WAIT_L(n) asm volatile("s_waitcnt lgkmcnt(" #n ")" ::: "memory")
#define PG8_BAR __builtin_amdgcn_s_barrier()
#define PG8_SCHED __builtin_amdgcn_sched_barrier(0)
    Unit cur, nxt; int ui = 0;
    if (!S.next(0, cur)) return;
    f32x4 acc[2][2][4][2];
#pragma unroll
    for (int a = 0; a < 2; ++a)
#pragma unroll
        for (int b = 0; b < 2; ++b)
#pragma unroll
            for (int m = 0; m < 4; ++m)
#pragma unroll
                for (int n = 0; n < 2; ++n) acc[a][b][m][n] = (f32x4){0.f, 0.f, 0.f, 0.f};
    bf16x8 At[4][2], B0[2][2], B1[2][2];
    const char* cA = (const char*)g.A + (size_t)cur.pm * tstep; const char* cB = (const char*)g.Bt + (size_t)cur.pn * tstep;
    S.a_ready(cur);
    if constexpr (SP2) {
        PG8_STAGE(PG8_SB(0, 0), cB, voffB); PG8_STAGE(PG8_SB(0, 1), cB + hstep, voffB); PG8_STAGE(PG8_SA(0, 0), cA, voffA); PG8_STAGE(PG8_SA(0, 1), cA + hstep, voffA);
        if (wr == 1) PG8_BAR;
        PG8_WAIT_V(2); PG8_BAR;
        PG8_STAGE(PG8_SB(1, 0), cB + kstep, voffB); PG8_STAGE(PG8_SA(1, 0), cA + kstep, voffA); PG8_STAGE(PG8_SB(1, 1), cB + hstep + kstep, voffB);
        PG8_WAIT_V(6); PG8_BAR;
    } else {
        PG8_STAGE(PG8_SB(0, 0), cB, voffB); PG8_STAGE(PG8_SA(0, 0), cA, voffA); PG8_STAGE(PG8_SB(0, 1), cB + hstep, voffB); PG8_STAGE(PG8_SA(0, 1), cA + hstep, voffA);
        if (wr == 1) PG8_BAR;
        PG8_WAIT_V(4); PG8_BAR;
        PG8_STAGE(PG8_SB(1, 0), cB + kstep, voffB); PG8_STAGE(PG8_SA(1, 0), cA + kstep, voffA); PG8_STAGE(PG8_SB(1, 1), cB + hstep + kstep, voffB);
        PG8_WAIT_V(6); PG8_BAR;
    }
    for (;;) {
        const bool has_next = S.next(ui + 1, nxt);
        const char* nA = has_next ? (const char*)g.A + (size_t)nxt.pm * tstep : cA; const char* nB = has_next ? (const char*)g.Bt + (size_t)nxt.pn * tstep : cB;
        for (int t = 0; t < nt; t += 2) {
            const bool last = (t == nt - 2);
            const char* a1 = cA + (size_t)(t + 1) * kstep;
            const char* a2 = last ? nA : cA + (size_t)(t + 2) * kstep; const char* b2 = last ? nB : cB + (size_t)(t + 2) * kstep;
            const char* a3 = a2 + kstep; const char* b3 = b2 + kstep;
            if (last && has_next) S.a_ready(nxt);
            if constexpr (SP2) {
            PG8_LDB(B0, 0, 0); PG8_LDB(B1, 0, 1); PG8_SCHED; PG8_LDA(At, 0, 0); PG8_STAGE(PG8_SA(1, 1), a1 + hstep, voffA);
            PG8_WAIT_V(8); PG8_WAIT_L(0); PG8_BAR; PG8_MMA(0, 0, At, B0); PG8_MMA(0, 1, At, B1); PG8_BAR; PG8_SCHED;
            PG8_LDA(At, 0, 1); PG8_STAGE(PG8_SB(0, 0), b2, voffB); PG8_STAGE(PG8_SB(0, 1), b2 + hstep, voffB); PG8_STAGE(PG8_SA(0, 0), a2, voffA);
            PG8_WAIT_V(8); PG8_WAIT_L(0); PG8_BAR; PG8_MMA(1, 0, At, B0); PG8_MMA(1, 1, At, B1); PG8_BAR; PG8_SCHED;
            PG8_LDB(B0, 1, 0); PG8_LDB(B1, 1, 1); PG8_SCHED; PG8_LDA(At, 1, 0); PG8_STAGE(PG8_SA(0, 1), a2 + hstep, voffA);
            PG8_WAIT_V(8); PG8_WAIT_L(0); PG8_BAR; PG8_MMA(0, 0, At, B0); PG8_MMA(0, 1, At, B1); PG8_BAR; PG8_SCHED;
            PG8_LDA(At, 1, 1); PG8_STAGE(PG8_SB(1, 0), b3, voffB); PG8_STAGE(PG8_SB(1, 1), b3 + hstep, voffB); PG8_STAGE(PG8_SA(1, 0), a3, voffA);
            PG8_WAIT_V(8); PG8_WAIT_L(0); PG8_BAR; PG8_MMA(1, 0, At, B0); PG8_MMA(1, 1, At, B1); PG8_BAR; PG8_SCHED;
            } else {
            PG8_LDB(B0, 0, 0); PG8_SCHED; PG8_LDA(At, 0, 0); PG8_STAGE(PG8_SA(1, 1), a1 + hstep, voffA);
            PG8_WAIT_L(8); PG8_BAR; PG8_WAIT_L(0); PG8_MMA(0, 0, At, B0); PG8_BAR; PG8_SCHED;
            PG8_LDB(B1, 0, 1); PG8_STAGE(PG8_SB(0, 0), b2, voffB);
            PG8_BAR; PG8_WAIT_L(0); PG8_MMA(0, 1, At, B1); PG8_BAR;
            PG8_LDA(At, 0, 1); PG8_STAGE(PG8_SA(0, 0), a2, voffA);
            PG8_BAR; PG8_WAIT_L(0); PG8_MMA(1, 0, At, B0); PG8_BAR; PG8_SCHED;
            PG8_STAGE(PG8_SB(0, 1), b2 + hstep, voffB);
            PG8_WAIT_V(6); PG8_BAR; PG8_MMA(1, 1, At, B1); PG8_BAR;
            PG8_LDB(B0, 1, 0); PG8_SCHED; PG8_LDA(At, 1, 0); PG8_STAGE(PG8_SA(0, 1), a2 + hstep, voffA);
            PG8_WAIT_L(8); PG8_BAR; PG8_WAIT_L(0); PG8_MMA(0, 0, At, B0); PG8_BAR; PG8_SCHED;
            PG8_LDB(B1, 1, 1); PG8_STAGE(PG8_SB(1, 0), b3, voffB);
            PG8_BAR; PG8_WAIT_L(0); PG8_MMA(0, 1, At, B1); PG8_BAR;
            PG8_LDA(At, 1, 1); PG8_STAGE(PG8_SA(1, 0), a3, voffA);
            PG8_BAR; PG8_WAIT_L(0); PG8_MMA(1, 0, At, B0); PG8_BAR; PG8_SCHED;
            PG8_STAGE(PG8_SB(1, 1), b3 + hstep, voffB);
            PG8_WAIT_V(6); PG8_BAR; PG8_MMA(1, 1, At, B1); PG8_BAR;
            }
        }
        if constexpr (ALIGN_EPI) { if (wr == 0) PG8_BAR; }
        if constexpr (!Epi::AFTER_DRAIN) { E(acc, cur, wr, wc, fr, fq); S.done(cur); }
        if (!has_next) break;
#pragma unroll
        for (int a = 0; a < 2; ++a)
#pragma unroll
            for (int b = 0; b < 2; ++b)
#pragma unroll
                for (int m = 0; m < 4; ++m)
#pragma unroll
                    for (int n = 0; n < 2; ++n) acc[a][b][m][n] = (f32x4){0.f, 0.f, 0.f, 0.f};
        cur = nxt; cA = nA; cB = nB; ++ui;
        if constexpr (ALIGN_EPI) { if (wr == 1) PG8_BAR; }
    }
    PG8_WAIT_V(0);
    if constexpr (!ALIGN_EPI) { if (wr == 0) PG8_BAR; }
    PG8_BAR;
    if constexpr (Epi::AFTER_DRAIN) { E.fused(acc, cur, wr, wc, fr, fq, lds, wid, lane); S.done(cur); }
#undef PG8_SA
#undef PG8_SB
#undef PG8_STAGE
#undef PG8_LDA
#undef PG8_LDB
#undef PG8_MMA
#undef PG8_WAIT_V
#undef PG8_WAIT_L
#undef PG8_BAR
#undef PG8_SCHED
}
}

#ifndef PG8_SP2
#define PG8_SP2 true
#endif
#ifndef PG8_ALIGN
#define PG8_ALIGN true
#endif
#include <hip/hip_bf16.h>
#include <cmath>
namespace attn_body {
using bf16=__hip_bfloat16;
using bf16x8=__attribute__((ext_vector_type(8)))short;
using s16x4=__attribute__((ext_vector_type(4)))short;
using f32x16=__attribute__((ext_vector_type(16)))float;
using u32x4=__attribute__((ext_vector_type(4)))unsigned;
constexpr int BATCH=4,NHEAD=8,SEQ=8192,D=64,DM=NHEAD*D,ODM=1024;
constexpr int NW=8,QBLK=32,QB=QBLK*NW,KVBLK=64,NQB=SEQ/QB;
constexpr int ATTN_PITCH=DM, ATTN_UNIT_ROWS=QB; constexpr int LDS_EXTRA=86016; constexpr float LOG2E=1.4426950408889634f;
__device__ __forceinline__ int crow(int r,int hi){return (r&3)+8*(r>>2)+4*hi;}
#define SBAR() __builtin_amdgcn_sched_barrier(0)
__device__ __forceinline__ void cmask(f32x16&p0,f32x16&p1,int jb,int qrel,int hi){
  const float NEG=-INFINITY; int kb=64*jb+4*hi;
  #pragma unroll
  for(int r=0;r<16;++r){int kv=kb+(r&3)+8*(r>>2); if(kv>qrel)p0[r]=NEG; if(kv+32>qrel)p1[r]=NEG;}
}


typedef float f32x4v __attribute__((ext_vector_type(4)));
typedef __attribute__((address_space(3))) const char* lds_cptr0;
template<int MODE> __device__ __forceinline__ void cinit(f32x16&p0,f32x16&p1,int t,int NT,float mhat,int qrel,int hi,lds_cptr0 xb,int kcd){
  if constexpr(MODE==0){
    const __attribute__((address_space(3))) float*kb_=(const __attribute__((address_space(3))) float*)xb+64*t+4*hi;
    #pragma unroll
    for(int j=0;j<4;++j){ const f32x4v a=*(const __attribute__((address_space(3))) f32x4v*)(kb_+8*j); const f32x4v c=*(const __attribute__((address_space(3))) f32x4v*)(kb_+32+8*j);
      #pragma unroll
      for(int i=0;i<4;++i){p0[4*j+i]=a[i]-mhat;p1[4*j+i]=c[i]-mhat;} }
    const int jb=t-(NT-4); if(jb>=0)cmask(p0,p1,jb,qrel,hi);
  } else {
    const __attribute__((address_space(3))) float*tab=(const __attribute__((address_space(3))) float*)xb;
    const int dc=kcd-t;
    if(dc<0||dc>8){
      #pragma unroll
      for(int r=0;r<16;++r){p0[r]=-INFINITY;p1[r]=-INFINITY;}
    } else if(dc>=3){ const float c=tab[256]-mhat;
      #pragma unroll
      for(int r=0;r<16;++r){p0[r]=c;p1[r]=c;}
    } else { const int base=64*dc+(qrel&63)-4*hi+128;
      #pragma unroll
      for(int r=0;r<16;++r){ int d=base-((r&3)+8*(r>>2)); int i0=d<0?0:(d>256?256:d); int d1=d-32; int i1=d1<0?0:(d1>256?256:d1); p0[r]=tab[i0]-mhat; p1[r]=tab[i1]-mhat; }
    }
  }
}

constexpr int NSLOT=3, SLOTB=8192;
constexpr int LDS_K=0, LDS_V=NSLOT*SLOTB, LDS_WS=2*NSLOT*SLOTB, LDS_OST=LDS_WS+NW*64*4, LDS_BYTES=LDS_OST+NW*4096;
constexpr float C2=0.125f*1.4426950408889634f;
__device__ __forceinline__ void glds16(const void*gsrc,unsigned lds_dst){unsigned keep;
  asm volatile("s_mov_b32 %0, m0\n\ts_mov_b32 m0, %2\n\ts_nop 0\n\tglobal_load_lds_dwordx4 %1, off\n\ts_mov_b32 m0, %0":"=&s"(keep):"v"(gsrc),"s"(lds_dst):"memory");}
__device__ __forceinline__ float max3f(float a,float b,float c){float r;asm("v_max3_f32 %0, %1, %2, %3":"=v"(r):"v"(a),"v"(b),"v"(c));return r;}
__device__ __forceinline__ float max2f(float a,float b){float r;asm("v_max_f32_e32 %0, %1, %2":"=v"(r):"v"(a),"v"(b));return r;}
__device__ __forceinline__ float fadd_s(float a,float b){float r;asm("v_add_f32_e32 %0, %1, %2":"=v"(r):"v"(a),"v"(b));return r;}
__device__ __forceinline__ float fsub_s(float a,float b){float r;asm("v_sub_f32_e32 %0, %1, %2":"=v"(r):"v"(a),"v"(b));return r;}
typedef float f32x2_t __attribute__((ext_vector_type(2))); typedef __bf16 bf16x2_t __attribute__((ext_vector_type(2)));
__device__ __forceinline__ unsigned cvtpk_s(float lo,float hi){f32x2_t v={lo,hi};bf16x2_t b=__builtin_convertvector(v,bf16x2_t);return __builtin_bit_cast(unsigned,b);}
#define WAIT_BAR(N) asm volatile("s_waitcnt vmcnt(" #N ") lgkmcnt(0)\n\ts_barrier":::"memory")

__device__ __forceinline__ void qkt(f32x16&p0,f32x16&p1,const char*Kslot,const bf16x8*qr,int r32,int hi){
  const char*kb=Kslot+hi*1024+r32*16;
  #pragma unroll
  for(int d0=0;d0<4;++d0){
    const bf16x8 b0=*reinterpret_cast<const bf16x8*>(kb+d0*2048);
    const bf16x8 b1=*reinterpret_cast<const bf16x8*>(kb+d0*2048+512);
    {p0=__builtin_amdgcn_mfma_f32_32x32x16_bf16(b0,qr[d0],p0,0,0,0);p1=__builtin_amdgcn_mfma_f32_32x32x16_bf16(b1,qr[d0],p1,0,0,0);}}
}
typedef __attribute__((address_space(3))) const char* lds_cptr;
typedef short v4i16_t __attribute__((ext_vector_type(4)));
__device__ __forceinline__ void kload8(bf16x8*kf,lds_cptr kp){
  kf[0]=*(const __attribute__((address_space(3))) bf16x8*)(kp);      kf[1]=*(const __attribute__((address_space(3))) bf16x8*)(kp+512);
  kf[2]=*(const __attribute__((address_space(3))) bf16x8*)(kp+2048); kf[3]=*(const __attribute__((address_space(3))) bf16x8*)(kp+2560);
  kf[4]=*(const __attribute__((address_space(3))) bf16x8*)(kp+4096); kf[5]=*(const __attribute__((address_space(3))) bf16x8*)(kp+4608);
  kf[6]=*(const __attribute__((address_space(3))) bf16x8*)(kp+6144); kf[7]=*(const __attribute__((address_space(3))) bf16x8*)(kp+6656);
}
__device__ __forceinline__ void kload2(bf16x8*kf,lds_cptr kp,int j){ kf[2*j]=*(const __attribute__((address_space(3))) bf16x8*)(kp+j*2048); kf[2*j+1]=*(const __attribute__((address_space(3))) bf16x8*)(kp+j*2048+512); }
__device__ __forceinline__ s16x4 vtr(lds_cptr p){ return __builtin_bit_cast(s16x4,__builtin_amdgcn_ds_read_tr16_b64_v4i16((__attribute__((address_space(3))) v4i16_t*)p)); }
__device__ __forceinline__ float rowmax(const f32x16&p0,const f32x16&p1){
  float a=max3f(p0[0],p0[1],p1[0]),b=max3f(p0[2],p0[3],p1[1]);a=max3f(a,p1[2],p1[3]);
  #pragma unroll
  for(int r=4;r<16;r+=4){a=max3f(a,p0[r],p0[r+1]);b=max3f(b,p0[r+2],p0[r+3]);a=max3f(a,p1[r],p1[r+1]);b=max3f(b,p1[r+2],p1[r+3]);}
  const float m=max2f(a,b);
  auto rr=__builtin_amdgcn_permlane32_swap(__float_as_uint(m),__float_as_uint(m),false,false);
  return max2f(__uint_as_float(rr[0]),__uint_as_float(rr[1]));
}
__device__ __forceinline__ void pv(f32x16*o,int vb,bf16x8 pa0,bf16x8 pa1,bf16x8 pa2,bf16x8 pa3){
  #pragma unroll
  for(int d0=0;d0<2;++d0){s16x4 lo[4],hi[4];
    #pragma unroll
    for(int ks=0;ks<4;++ks){
      asm volatile("ds_read_b64_tr_b16 %0,%1 offset:%c2":"=&v"(lo[ks]):"v"(vb),"i"(d0*4096+ks*1024):"memory");
      asm volatile("ds_read_b64_tr_b16 %0,%1 offset:%c2":"=&v"(hi[ks]):"v"(vb),"i"(d0*4096+ks*1024+512):"memory");}
    asm volatile("s_waitcnt lgkmcnt(0)":::"memory");SBAR();
    #define PK(k) (bf16x8){lo[k][0],lo[k][1],lo[k][2],lo[k][3],hi[k][0],hi[k][1],hi[k][2],hi[k][3]}
    o[d0]=__builtin_amdgcn_mfma_f32_32x32x16_bf16(pa0,PK(0),o[d0],0,0,0);
    o[d0]=__builtin_amdgcn_mfma_f32_32x32x16_bf16(pa1,PK(1),o[d0],0,0,0);
    o[d0]=__builtin_amdgcn_mfma_f32_32x32x16_bf16(pa2,PK(2),o[d0],0,0,0);
    o[d0]=__builtin_amdgcn_mfma_f32_32x32x16_bf16(pa3,PK(3),o[d0],0,0,0);
    #undef PK
  }
}

#ifndef ATTN_STORE16
#define ATTN_STORE16(p,v) (*(u32x4*)(p)=(v))
#endif
template<int MODE,int THRL> __device__ __forceinline__ void attn_unit(int b,int h,int qb,const bf16*Q,const bf16*__restrict__ K,const bf16*__restrict__ V,bf16*O,const float*__restrict__ xsrc,char*shm){
  int tid_=threadIdx.x; asm volatile("":"+v"(tid_)); const int tid=tid_,lane=tid&63,r32=lane&31,hi=lane>>5; const int wid=__builtin_amdgcn_readfirstlane(tid>>6);
  const long rowbase=(long)b*SEQ; const int q0=qb*QB;
  const bf16*Qw=Q+(rowbase+q0+wid*QBLK)*DM+h*D;
  const int t0=(MODE==1)?((4*qb-8)>0?(4*qb-8):0):0; const bf16*Kh=K+(rowbase+(long)t0*KVBLK)*DM+h*D,*Vh=V+(rowbase+(long)t0*KVBLK)*DM+h*D;
  const unsigned lds0=(unsigned)(uintptr_t)shm;
  float*wsf=(float*)(shm+LDS_WS)+wid*64;
  const bf16*ksrc=Kh+(long)lane*DM+wid*8;
  const bf16*vsrc=Vh+(long)(16*(wid&3)+(lane>>2))*DM+(wid>>2)*32+(lane&3)*8;
  const unsigned kdst=lds0+LDS_K+wid*1024, vdst=lds0+LDS_V+wid*1024;
  #define DMA_K(t,slot) glds16(ksrc+(long)(t)*KVBLK*DM,(unsigned)__builtin_amdgcn_readfirstlane(kdst+(slot)))
  #define DMA_V(t,slot) glds16(vsrc+(long)(t)*KVBLK*DM,(unsigned)__builtin_amdgcn_readfirstlane(vdst+(slot)))
  const int vb0=(int)(lds0+LDS_V)+((lane>>4)&1)*32+(lane&3)*8+(4*hi+((lane&15)>>2))*64;
  const char*Kbase=shm+LDS_K; bf16x8 kf[8];
  const lds_cptr shm3=(lds_cptr)shm; const lds_cptr kp0=shm3+LDS_K+hi*1024+r32*16; const lds_cptr vp0=shm3+LDS_V+((lane>>4)&1)*32+(lane&3)*8+(4*hi+((lane&15)>>2))*64;
  const int NT=(q0+QB)/KVBLK-t0;
  const lds_cptr xb=shm3+LDS_EXTRA; const int kcd=4*qb+(wid>>1)-t0;
  { __attribute__((address_space(3))) float*xw=(__attribute__((address_space(3))) float*)(shm3+LDS_EXTRA);
    if constexpr(MODE==0){ const int n=NT*KVBLK; for(int i=tid*4;i<n;i+=2048){ const f32x4v v=*(const f32x4v*)(xsrc+i); *(__attribute__((address_space(3))) f32x4v*)(xw+i)=v; } }
    else { if(tid<257) xw[tid]=xsrc[tid]*LOG2E; } }
  DMA_K(0,0);DMA_V(0,0);DMA_K(1,SLOTB);
  bf16x8 qr[4];
  #pragma unroll
  for(int d0=0;d0<4;++d0)qr[d0]=*reinterpret_cast<const bf16x8*>(&Qw[(long)r32*DM+d0*16+hi*8]);
  float mhat=0.f,l_reg=0.f;f32x16 o[2];o[0]=f32x16{};o[1]=f32x16{};
  const int qrel=wid*QBLK+r32;
  #define CINIT(P0,P1,t) cinit<MODE>(P0,P1,(t),NT,mhat,qrel,hi,xb,kcd)
  bool resc=false;
  #define START(P0,P1) do{ const float rm=rowmax(P0,P1); resc=false; \
    { const float dl=(MODE==1)?__builtin_fmaxf(rm,-100.f):rm; mhat=fadd_s(mhat,dl); \
      _Pragma("unroll") for(int r=0;r<16;++r){P0[r]=fsub_s(P0[r],dl);P1[r]=fsub_s(P1[r],dl);} \
      } \
    _Pragma("unroll") for(int r=0;r<16;++r)P0[r]=__builtin_amdgcn_exp2f(P0[r]); }while(0)
  #define RESC() do{ if(resc){ asm volatile("s_waitcnt lgkmcnt(0)":::"memory"); \
      _Pragma("unroll") for(int d_=0;d_<2;++d_) _Pragma("unroll") for(int r=0;r<16;++r)o[d_][r]*=wsf[crow(r,hi)]; } }while(0)
  f32x16 pA0,pA1,pB0,pB1;
  int sl_prev=0,sl_cur=0,sl_next=SLOTB;
  #define ROT() do{sl_prev=sl_cur;sl_cur=sl_next;sl_next=(sl_next==(NSLOT-1)*SLOTB)?0:sl_next+SLOTB;}while(0)
  DMA_K(2,2*SLOTB);
  WAIT_BAR(3);
  CINIT(pA0,pA1,0); qkt(pA0,pA1,Kbase,qr,r32,hi);asm volatile("s_nop 15\n\ts_nop 7":"+v"(pA0),"+v"(pA1));
  START(pA0,pA1);
  _Pragma("unroll") for(int r=0;r<16;++r)pA1[r]=__builtin_amdgcn_exp2f(pA1[r]);
  CINIT(pB0,pB1,1);
  WAIT_BAR(0);
  DMA_K(3,0);DMA_V(1,SLOTB);
  ROT();
  kload8(kf,kp0+sl_cur);
  WAIT_BAR(2);
  s16x4 vlo[8],vhi[8]; u32x4 pw0,pw1,pw2,pw3;
  #define PKW(P,B) cvtpk_s(P[B],P[B+1])
  #define PAF(k) __builtin_bit_cast(bf16x8,pw##k)
  #define VFR(i) (bf16x8){vlo[i][0],vlo[i][1],vlo[i][2],vlo[i][3],vhi[i][0],vhi[i][1],vhi[i][2],vhi[i][3]}
  #define PIN(x) asm volatile("":"+v"(x))
  #define MX3(a,b,c) __builtin_fmaxf(__builtin_fmaxf((a),(b)),(c))
  #define GAPA(MF,A0,A1,A2,A3,W0,W1,PW) do{ MF; sacc+=A0; sacc+=A1; sacc+=A2; sacc+=A3; PIN(sacc); W0; W1; PIN(PW); SBAR(); }while(0)
  #define EX(v) __builtin_amdgcn_exp2f(v)
  #define GAPB(MF,X,B) do{ MF; X[B]=EX(X[B]); X[B+1]=EX(X[B+1]); X[B+2]=EX(X[B+2]); X[B+3]=EX(X[B+3]); PIN(X); SBAR(); }while(0)
  #define VRD(i) do{ vlo[i]=vtr(vp_+(((i)>>2)*4096+((i)&3)*1024)); vhi[i]=vtr(vp_+(((i)>>2)*4096+((i)&3)*1024+512)); }while(0)
  #define KRD(G,j) do{ if(G){ kload2(kf,kp0+sl_next,j); SBAR(); } }while(0)
  #define STEP(C0,C1,P0,P1,t,GK,GV,GL,GI) do{ SBAR(); \
    const lds_cptr vp_=vp0+sl_prev; \
    VRD(0); SBAR(); float sacc=(P0[0]+P0[1]); \
    GAPA(C0=__builtin_amdgcn_mfma_f32_32x32x16_bf16(kf[0],qr[0],C0,0,0,0), P0[2],P0[3],P0[4],P0[5],     pw0[0]=PKW(P0,0), pw0[1]=PKW(P0,2), pw0); \
    VRD(4); SBAR(); GAPA(C1=__builtin_amdgcn_mfma_f32_32x32x16_bf16(kf[1],qr[0],C1,0,0,0), P0[6],P0[7],P0[8],P0[9],     pw0[2]=PKW(P0,4), pw0[3]=PKW(P0,6), pw0); \
    VRD(1); SBAR(); GAPA(C0=__builtin_amdgcn_mfma_f32_32x32x16_bf16(kf[2],qr[1],C0,0,0,0),   P0[10],P0[11],P0[12],P0[13], pw1[0]=PKW(P0,8), pw1[1]=PKW(P0,10), pw1); \
    VRD(5); SBAR(); GAPA(C1=__builtin_amdgcn_mfma_f32_32x32x16_bf16(kf[3],qr[1],C1,0,0,0),   P0[14],P0[15],P1[0],P1[1],   pw1[2]=PKW(P0,12),pw1[3]=PKW(P0,14), pw1); \
    VRD(2); SBAR(); GAPA(C0=__builtin_amdgcn_mfma_f32_32x32x16_bf16(kf[4],qr[2],C0,0,0,0),   P1[2],P1[3],P1[4],P1[5],     pw2[0]=PKW(P1,0), pw2[1]=PKW(P1,2), pw2); \
    VRD(6); SBAR(); GAPA(C1=__builtin_amdgcn_mfma_f32_32x32x16_bf16(kf[5],qr[2],C1,0,0,0),   P1[6],P1[7],P1[8],P1[9],     pw2[2]=PKW(P1,4), pw2[3]=PKW(P1,6), pw2); \
    VRD(3); SBAR(); GAPA(C0=__builtin_amdgcn_mfma_f32_32x32x16_bf16(kf[6],qr[3],C0,0,0,0),   P1[10],P1[11],P1[12],P1[13], pw3[0]=PKW(P1,8), pw3[1]=PKW(P1,10), pw3); \
    VRD(7); SBAR(); GAPA(C1=__builtin_amdgcn_mfma_f32_32x32x16_bf16(kf[7],qr[3],C1,0,0,0),   P1[14],P1[15],0.f,0.f,       pw3[2]=PKW(P1,12),pw3[3]=PKW(P1,14), pw3); \
    l_reg+=sacc; \
    if(GK){DMA_K((t)+3,sl_cur);} if(GV){DMA_V((t)+1,sl_next);} \
    { float a=MX3(C0[0],C0[1],C1[0]),b=MX3(C0[2],C0[3],C1[1]); a=MX3(a,C1[2],C1[3]); \
      _Pragma("unroll") for(int r=4;r<16;r+=4){a=MX3(a,C0[r],C0[r+1]);b=MX3(b,C0[r+2],C0[r+3]);a=MX3(a,C1[r],C1[r+1]);b=MX3(b,C1[r+2],C1[r+3]);} \
      float rm=__builtin_fmaxf(a,b); { auto rr=__builtin_amdgcn_permlane32_swap(__float_as_uint(rm),__float_as_uint(rm),false,false); rm=__builtin_fmaxf(__uint_as_float(rr[0]),__uint_as_float(rr[1])); } \
      resc=false; \
      if(__builtin_expect(__any(rm>(float)THRL),0)){ const float dl=__builtin_fmaxf(rm,0.f); mhat+=dl; \
        _Pragma("unroll") for(int r=0;r<16;++r){C0[r]-=dl;C1[r]-=dl;} \
        const float f=__builtin_amdgcn_exp2f(-dl); l_reg*=f; if(hi==0)wsf[r32]=f; resc=true; } } \
    if(GI){ CINIT(P0,P1,(t)+1); } \
    SBAR(); \
    GAPB(o[0]=__builtin_amdgcn_mfma_f32_32x32x16_bf16(PAF(0),VFR(0),o[0],0,0,0), C0,0); \
    GAPB(o[1]=__builtin_amdgcn_mfma_f32_32x32x16_bf16(PAF(0),VFR(4),o[1],0,0,0), C0,4); \
    KRD(GL,0); GAPB(o[0]=__builtin_amdgcn_mfma_f32_32x32x16_bf16(PAF(1),VFR(1),o[0],0,0,0), C0,8); \
    KRD(GL,1); GAPB(o[1]=__builtin_amdgcn_mfma_f32_32x32x16_bf16(PAF(1),VFR(5),o[1],0,0,0), C0,12); \
    KRD(GL,2); GAPB(o[0]=__builtin_amdgcn_mfma_f32_32x32x16_bf16(PAF(2),VFR(2),o[0],0,0,0), C1,0); \
    KRD(GL,3); GAPB(o[1]=__builtin_amdgcn_mfma_f32_32x32x16_bf16(PAF(2),VFR(6),o[1],0,0,0), C1,4); \
    GAPB(o[0]=__builtin_amdgcn_mfma_f32_32x32x16_bf16(PAF(3),VFR(3),o[0],0,0,0), C1,8); \
    GAPB(o[1]=__builtin_amdgcn_mfma_f32_32x32x16_bf16(PAF(3),VFR(7),o[1],0,0,0), C1,12); \
    }while(0)
  int t=1;
  for(;t+5<NT;t+=2){
    STEP(pB0,pB1,pA0,pA1,t,true,true,true,true);     WAIT_BAR(2); RESC(); ROT();
    STEP(pA0,pA1,pB0,pB1,t+1,true,true,true,true);   WAIT_BAR(2); RESC(); ROT();
  }
  #define ENDW(tt) do{ if((tt)+3<NT){WAIT_BAR(2);} else if((tt)+2<NT){WAIT_BAR(1);} else {WAIT_BAR(0);} }while(0)
  for(;t+1<NT;t+=2){
    STEP(pB0,pB1,pA0,pA1,t,(t+3<NT),(t+1<NT),(t+1<NT),true);       ENDW(t);   RESC(); ROT();
    STEP(pA0,pA1,pB0,pB1,t+1,(t+4<NT),(t+2<NT),(t+2<NT),true);     ENDW(t+1); RESC(); ROT();
  }
  STEP(pB0,pB1,pA0,pA1,NT-1,false,false,false,false); RESC();
  { float sacc=pB0[0]+pB0[1]; _Pragma("unroll") for(int r=2;r<16;++r)sacc+=pB0[r]; _Pragma("unroll") for(int r=0;r<16;++r)sacc+=pB1[r]; l_reg+=sacc;
    pw0=(u32x4){PKW(pB0,0),PKW(pB0,2),PKW(pB0,4),PKW(pB0,6)};pw1=(u32x4){PKW(pB0,8),PKW(pB0,10),PKW(pB0,12),PKW(pB0,14)};pw2=(u32x4){PKW(pB1,0),PKW(pB1,2),PKW(pB1,4),PKW(pB1,6)};pw3=(u32x4){PKW(pB1,8),PKW(pB1,10),PKW(pB1,12),PKW(pB1,14)};
    SBAR(); pv(o,vb0+sl_cur,PAF(0),PAF(1),PAF(2),PAF(3)); }
  #undef PKW
  #undef PAF
  #undef VFR
  #undef PIN
  #undef MX3
  #undef GAPA
  #undef GAPB
  #undef EX
  #undef VRD
  #undef KRD
  #undef STEP
  #undef ENDW
  {auto rr=__builtin_amdgcn_permlane32_swap(__float_as_uint(l_reg),__float_as_uint(l_reg),false,false);l_reg=__uint_as_float(rr[0])+__uint_as_float(rr[1]);}
  if(hi==0)wsf[32+r32]=l_reg;asm volatile("s_waitcnt lgkmcnt(0)":::"memory");
  float rli[16];
  #pragma unroll
  for(int r=0;r<16;++r)rli[r]=__builtin_amdgcn_rcpf(wsf[32+crow(r,hi)]);
  bf16*Ow=O+(rowbase+q0+wid*QBLK)*ODM+MODE*512+h*D;
  { bf16*stg=(bf16*)(shm+LDS_OST)+wid*2048;
    #pragma unroll
    for(int r=0;r<16;++r){const int orow=crow(r,hi);
      #pragma unroll
      for(int d0=0;d0<2;++d0)stg[orow*64+d0*32+r32]=__float2bfloat16(o[d0][r]*rli[r]);}
    asm volatile("s_waitcnt lgkmcnt(0)":::"memory");
    #pragma unroll
    for(int i=0;i<4;++i){const int row=i*8+(lane>>3),ch=lane&7; const u32x4 v=*(const u32x4*)(stg+row*64+ch*8); ATTN_STORE16(Ow+(long)row*ODM+ch*8,v);} }
  asm volatile("s_waitcnt lgkmcnt(0)\n\ts_barrier":::"memory");
  #undef DMA_K
  #undef DMA_V
  #undef CINIT
  #undef START
  #undef RESC
  #undef ROT
}
constexpr int ATTN_LDS_BYTES=LDS_BYTES;
struct AttnTensors { const bf16* QA; const bf16* KA; const bf16* VA; const bf16* QB_; const bf16* KB_; const bf16* VB_; bf16* O; const float* kbias; const float* relb; };
struct AttnUnit { int bh; int qb; int mode; };
struct StaticOrder {
  int vcu;
  __device__ __forceinline__ explicit StaticOrder(int grid,int block):vcu((block%8)*(grid/8)+block/8){}
  __device__ __forceinline__ bool next(int i,AttnUnit&u)const{ if(i>=8)return false; const int s=vcu&7,ii=i&3; u.bh=vcu>>3; u.mode=i>>2; u.qb=(ii==0)?s:(ii==1)?15-s:(ii==2)?16+s:31-s; return true; }
};
template<class Sched,int THRL=8> __device__ __forceinline__ void attn_phase(char*lds,const AttnTensors&T,const Sched&S){
  AttnUnit u;
  for(int i=0;S.next(i,u);++i){ const int b=u.bh/NHEAD,h=u.bh%NHEAD;
    if(u.mode==0) attn_unit<0,THRL>(b,h,u.qb,T.QA,T.KA,T.VA,T.O,T.kbias+(size_t)u.bh*SEQ,lds);
    else          attn_unit<1,THRL>(b,h,u.qb,T.QB_,T.KB_,T.VB_,T.O,T.relb+h*257,lds); }
}
#undef SBAR
#undef WAIT_BAR
}
namespace pg8 {
struct EpiResF32 {
    static constexpr bool PERM = false, AFTER_DRAIN = false;
    const float* base; float* out; int ldc; float alpha;
    __device__ __forceinline__ void operator()(const f32x4 (&acc)[2][2][4][2], const Unit& u, int wr, int wc, int fr, int fq) const {
        const int col0 = u.pn * BM + wc * 32 + 4 * fq;
#pragma unroll
        for (int ai = 0; ai < 2; ++ai)
#pragma unroll
            for (int m = 0; m < 4; ++m) { const size_t off = (size_t)(u.pm * BM + ai * HALF + wr * 64 + m * 16 + fr) * ldc + col0;
                f32x4 bs[2][2];
#pragma unroll
                for (int bj = 0; bj < 2; ++bj)
#pragma unroll
                    for (int n = 0; n < 2; ++n) bs[bj][n] = *(const f32x4*)(base + off + bj * HALF + n * 16);
#pragma unroll
                for (int bj = 0; bj < 2; ++bj)
#pragma unroll
                    for (int n = 0; n < 2; ++n) *(f32x4*)(out + off + bj * HALF + n * 16) = bs[bj][n] * alpha + acc[ai][bj][m][n];
                asm volatile("" ::: "memory"); }
    }
};
__device__ __forceinline__ float dppf_shr1(float old, float src) { return __builtin_bit_cast(float, __builtin_amdgcn_update_dpp(__builtin_bit_cast(int, old), __builtin_bit_cast(int, src), 0x111, 0xf, 0xf, false)); }
__device__ __forceinline__ float dppf_shr2(float old, float src) { return __builtin_bit_cast(float, __builtin_amdgcn_update_dpp(__builtin_bit_cast(int, old), __builtin_bit_cast(int, src), 0x112, 0xf, 0xf, false)); }
__device__ __forceinline__ float dppf_ror1(float src) { return __builtin_bit_cast(float, __builtin_amdgcn_update_dpp(0, __builtin_bit_cast(int, src), 0x121, 0xf, 0xf, false)); }
__device__ __forceinline__ float dppf_ror2(float src) { return __builtin_bit_cast(float, __builtin_amdgcn_update_dpp(0, __builtin_bit_cast(int, src), 0x122, 0xf, 0xf, false)); }
__device__ __forceinline__ float gelu_tanh_mul(float val, float g) {
    const float g2 = g * g; const float e = __builtin_amdgcn_exp2f(g * (g2 * -0.10294324f + -2.302208198f));
    return val * g * __builtin_amdgcn_rcpf(1.0f + e);
}
struct EpiConvGate {
    static constexpr bool PERM = true, AFTER_DRAIN = false;
    bf16_t* G; int FF; const float* cw; const float* cb; float* SB; PG8_LAS float* ex;
    __device__ __forceinline__ void operator()(const f32x4 (&acc)[2][2][4][2], const Unit& u, int wr, int wc, int fr, int fq) const {
        const int cl = wc * 32 + 8 * fq;
        const int NC = 2 * FF;
#pragma unroll
        for (int ai = 0; ai < 2; ++ai)
#pragma unroll
            for (int bj = 0; bj < 2; ++bj)
#pragma unroll
                for (int n = 0; n < 2; ++n) {
                    if (fr >= 14) *(PG8_LAS f32x4*)(ex + ((2 * ai + wr) * 2 + (fr - 14)) * 256 + bj * HALF + cl + 4 * n) = acc[ai][bj][3][n];
                }
        {
            float* sb = SB + (size_t)u.pm * 4 * NC;
#pragma unroll
            for (int bj = 0; bj < 2; ++bj)
#pragma unroll
                for (int n = 0; n < 2; ++n) { const int gc = bj * FF + u.pn * HALF + cl + 4 * n;
                    if (wr == 0 && fr < 2) *(f32x4*)(sb + (size_t)fr * NC + gc) = acc[0][bj][0][n];
                    if (wr == 1 && fr >= 14) *(f32x4*)(sb + (size_t)(fr - 12) * NC + gc) = acc[1][bj][3][n]; }
        }
        asm volatile("s_waitcnt lgkmcnt(0)" ::: "memory"); __builtin_amdgcn_s_barrier(); asm volatile("" ::: "memory");
#pragma unroll
        for (int ai = 0; ai < 2; ++ai) {
            const int blk = 2 * ai + wr;
            unsigned res[4][2][2];
#pragma unroll
            for (int n = 0; n < 2; ++n) {
                f32x4 w0[2], w1[2], w2[2], bb[2], wrap1[2], wrap2[2];
#pragma unroll
                for (int bj = 0; bj < 2; ++bj) { const int gc = bj * FF + u.pn * HALF + cl + 4 * n;
                    w0[bj] = *(const f32x4*)(cw + gc); w1[bj] = *(const f32x4*)(cw + NC + gc); w2[bj] = *(const f32x4*)(cw + 2 * NC + gc); bb[bj] = *(const f32x4*)(cb + gc);
                    wrap1[bj] = (f32x4){0.f, 0.f, 0.f, 0.f}; wrap2[bj] = wrap1[bj];
                    if (blk > 0) { const PG8_LAS float* e = ex + ((blk - 1) * 2) * 256 + bj * HALF + cl + 4 * n;
                        const f32x4 p2 = *(const PG8_LAS f32x4*)(e), p1 = *(const PG8_LAS f32x4*)(e + 256);
                        wrap1[bj] = p1; wrap2[bj] = (fr == 0) ? p2 : p1; } }
#pragma unroll
                for (int m = 0; m < 4; ++m) { f32x4 c[2];
#pragma unroll
                    for (int bj = 0; bj < 2; ++bj) { const f32x4 v = acc[ai][bj][m][n];
                        if (m > 0) { const f32x4 vp = acc[ai][bj][m - 1][n];
#pragma unroll
                            for (int e = 0; e < 4; ++e) { wrap1[bj][e] = dppf_ror1(vp[e]); wrap2[bj][e] = dppf_ror2(vp[e]); } }
#pragma unroll
                        for (int e = 0; e < 4; ++e) { const float pr1 = dppf_shr1(wrap1[bj][e], v[e]), pr2 = dppf_shr2(wrap2[bj][e], v[e]);
                            c[bj][e] = bb[bj][e] + w2[bj][e] * v[e] + w1[bj][e] * pr1 + w0[bj][e] * pr2; } }
                    f32x4 o;
#pragma unroll
                    for (int e = 0; e < 4; ++e) o[e] = gelu_tanh_mul(c[0][e], c[1][e]);
                    res[m][n][0] = cvt_pk_bf16(o[0], o[1]); res[m][n][1] = cvt_pk_bf16(o[2], o[3]); }
                asm volatile("" ::: "memory");
            }
#pragma unroll
            for (int m = 0; m < 4; ++m) { const size_t row = (size_t)u.pm * BM + ai * HALF + wr * 64 + m * 16 + fr;
                u32x4 w; w.x = res[m][0][0]; w.y = res[m][0][1]; w.z = res[m][1][0]; w.w = res[m][1][1];
                *(u32x4*)(G + row * FF + u.pn * HALF + cl) = w; }
            asm volatile("" ::: "memory");
        }
        asm volatile("s_waitcnt lgkmcnt(0)" ::: "memory"); __builtin_amdgcn_s_barrier(); asm volatile("" ::: "memory");
    }
};
}

#include <hip/hip_cooperative_groups.h>
namespace cg = cooperative_groups;
constexpr int NWAVES = 8;
constexpr int BATCH = 4, SEQ = 8192, DM_ = 1024, M = BATCH * SEQ;
constexpr int NHA = 8, PROJ = 3080, FCOL = 1536, NQKV = 3072, DFF = 2816, NUP = 2 * DFF;
constexpr float LN_EPS = 1e-5f, ALPHA = 1.189207115002721f;
constexpr size_t MiB = 1u << 20;
constexpr size_t WS_WIN = 2 * MiB, WS_WO = 8 * MiB, WS_WUP = 10 * MiB, WS_WDN = 21 * MiB, WS_LOGF = 27 * MiB, WS_KB = 28 * MiB, WS_SB = 30 * MiB;
constexpr size_t WS_XN = 42 * MiB, WS_Y = 106 * MiB, WS_QKV = 170 * MiB, WS_G = 170 * MiB, WS_END = 362 * MiB;
static_assert(WS_SB + (size_t)(M / 256) * 4 * NUP * 4 <= WS_XN && WS_G + (size_t)M * DFF * 2 <= WS_END && WS_QKV + (size_t)6 * M * 512 * 2 <= WS_END, "d_ws map");
constexpr int RING_BYTES = 131072, EX_OFF = RING_BYTES, LDS_BYTES = 147456;
#define LAS __attribute__((address_space(3)))
typedef unsigned short bf16;
typedef unsigned v4u __attribute__((ext_vector_type(4)));
typedef float f32x4 __attribute__((ext_vector_type(4)));
__device__ __forceinline__ unsigned f2bf(float f) { unsigned u = __builtin_bit_cast(unsigned, f); return (u + 0x7fffu + ((u >> 16) & 1u)) >> 16; }
__device__ __forceinline__ unsigned pk2(float lo, float hi) { return f2bf(lo) | (f2bf(hi) << 16); }
__device__ __forceinline__ float wave_sum(float v) {
#pragma unroll
    for (int o = 1; o < 64; o <<= 1) v += __shfl_xor(v, o);
    return v;
}
__device__ __forceinline__ void transpose_item(const float* W, int ld, int K, int c0, bf16* WT, int dst_row, LAS float* scr, int k0, int lane) {
#pragma unroll 8
    for (int i = 0; i < 32; ++i) { const int kk = 2 * i + (lane >> 5); scr[kk * 33 + (lane & 31)] = W[(size_t)(k0 + kk) * ld + c0 + (lane & 31)]; }
    asm volatile("s_waitcnt lgkmcnt(0)" ::: "memory");
    const int c = lane & 7;
#pragma unroll
    for (int j = 0; j < 4; ++j) { const int n = (lane >> 3) + 8 * j; const LAS float* s = scr + (8 * c) * 33 + n;
        v4u o; o.x = pk2(s[0 * 33], s[1 * 33]); o.y = pk2(s[2 * 33], s[3 * 33]); o.z = pk2(s[4 * 33], s[5 * 33]); o.w = pk2(s[6 * 33], s[7 * 33]);
        *(v4u*)(WT + (size_t)(dst_row + n) * K + k0 + 8 * c) = o; }
    asm volatile("s_waitcnt lgkmcnt(0)" ::: "memory");
}
__device__ __forceinline__ void ln_row(const float* xrow, float* orow, bf16* brow, const float* g, const float* bt, int lane) {
    const f32x4* xr = (const f32x4*)xrow + lane;
    f32x4 v[4]; float s = 0.f;
#pragma unroll
    for (int j = 0; j < 4; ++j) { v[j] = xr[64 * j]; s += (v[j].x + v[j].y) + (v[j].z + v[j].w); }
    const float mean = wave_sum(s) * (1.f / DM_); float s2 = 0.f;
#pragma unroll
    for (int j = 0; j < 4; ++j) { v[j] = v[j] - mean; s2 += (v[j].x * v[j].x + v[j].y * v[j].y) + (v[j].z * v[j].z + v[j].w * v[j].w); }
    const float rstd = 1.f / sqrtf(wave_sum(s2) * (1.f / DM_) + LN_EPS);
#pragma unroll
    for (int j = 0; j < 4; ++j) { const f32x4 gg = ((const f32x4*)g)[64 * j + lane], bb = ((const f32x4*)bt)[64 * j + lane]; v[j] = v[j] * rstd * gg + bb;
        ((f32x4*)orow)[64 * j + lane] = v[j];
        if (brow) ((unsigned long long*)brow)[64 * j + lane] = (unsigned long long)pk2(v[j].x, v[j].y) | ((unsigned long long)pk2(v[j].z, v[j].w) << 32); }
}

#ifndef PMASK
#define PMASK 0xff
#endif
struct Args { const float* in[13]; float* out; unsigned char* ws; };
__global__ void __launch_bounds__(NWAVES * 64, 2) mega_fwd(Args args) {
    extern __shared__ __attribute__((aligned(16))) unsigned char lds[];
    cg::grid_group grid = cg::this_grid();
    LAS unsigned char* L = (LAS unsigned char*)lds;
    const int G = gridDim.x, bx = blockIdx.x, vcu = (G % 8 == 0) ? (bx % 8) * (G / 8) + bx / 8 : bx;
#define PHASE_IDS() int tid_ = threadIdx.x; asm volatile("" : "+v"(tid_)); const int tid = tid_, lane = tid & 63, wave = __builtin_amdgcn_readfirstlane(tid >> 6); const int gw = vcu * NWAVES + wave, NGW = G * NWAVES; (void)gw; (void)NGW; (void)lane; (void)tid
    const float *x = args.in[0], *w_in = args.in[1], *b_forget = args.in[2], *rel_bias = args.in[3], *w_out = args.in[4], *ln1_g = args.in[5], *ln1_b = args.in[6],
                *w_up = args.in[7], *conv_w = args.in[8], *conv_b = args.in[9], *w_down = args.in[10], *ln2_g = args.in[11], *ln2_b = args.in[12];
    float* out = args.out; unsigned char* ws = args.ws;
    bf16 *WIN_t = (bf16*)(ws + WS_WIN), *WO_t = (bf16*)(ws + WS_WO), *WUP_t = (bf16*)(ws + WS_WUP), *WDN_t = (bf16*)(ws + WS_WDN);
    float *LOGF = (float*)(ws + WS_LOGF), *KBIAS = (float*)(ws + WS_KB), *SB = (float*)(ws + WS_SB);
    bf16 *XN = (bf16*)(ws + WS_XN), *Y = (bf16*)(ws + WS_Y), *QKV = (bf16*)(ws + WS_QKV), *GB = (bf16*)(ws + WS_G);

    if constexpr ((PMASK & 1) != 0) {
        PHASE_IDS();
        LAS float* scr = (LAS float*)(L + wave * 16384);
        constexpr int I_IN = 16 * 96, I_O = 16 * 32, I_UP = 16 * 176, I_DN = 44 * 32, NITEMS = I_IN + I_O + I_UP + I_DN;
        for (int it = gw; it < NITEMS; it += NGW) {
            int r = it;
            if (r < I_IN) { const int kb = r / 96, nb = r % 96; const int c0 = (nb < 48) ? 32 * nb : 1544 + 32 * (nb - 48); transpose_item(w_in, PROJ, DM_, c0, WIN_t, 32 * nb, scr, 64 * kb, lane); continue; } r -= I_IN;
            if (r < I_O) { const int kb = r / 32, nb = r % 32; transpose_item(w_out, DM_, DM_, 32 * nb, WO_t, 32 * nb, scr, 64 * kb, lane); continue; } r -= I_O;
            if (r < I_UP) { const int kb = r / 176, nb = r % 176; const int ch = 32 * nb; const int cc = (ch < DFF) ? ch : ch - DFF; const int dst = 256 * (cc / 128) + (cc % 128) + ((ch < DFF) ? 0 : 128);
                transpose_item(w_up, NUP, DM_, ch, WUP_t, dst, scr, 64 * kb, lane); continue; } r -= I_UP;
            { const int kb = r / 32, nb = r % 32; transpose_item(w_down, DM_, DFF, 32 * nb, WDN_t, 32 * nb, scr, 64 * kb, lane); }
        }
        __syncthreads();
        LAS float* wf = (LAS float*)L;
        for (int idx = tid; idx < 8192; idx += NWAVES * 64) { const int k = idx >> 3, h = idx & 7; wf[(((k >> 8) * 4 + (k & 3)) * 64 + ((k >> 2) & 63)) * 8 + h] = w_in[(size_t)k * PROJ + FCOL + h]; }
        __syncthreads();
        for (int m = gw; m < M; m += NGW) {
            const f32x4* xr = (const f32x4*)(x + (size_t)m * DM_) + lane;
            float f[8];
#pragma unroll
            for (int h = 0; h < 8; ++h) f[h] = 0.f;
#pragma unroll
            for (int j = 0; j < 4; ++j) { const f32x4 v = xr[64 * j];
                ((unsigned long long*)(XN + (size_t)m * DM_))[64 * j + lane] = (unsigned long long)pk2(v.x, v.y) | ((unsigned long long)pk2(v.z, v.w) << 32);
#pragma unroll
                for (int e = 0; e < 4; ++e) { const LAS f32x4* wp = (const LAS f32x4*)(wf + ((j * 4 + e) * 64 + lane) * 8); const f32x4 wa = wp[0], wb = wp[1]; const float xv = v[e];
                    f[0] += xv * wa.x; f[1] += xv * wa.y; f[2] += xv * wa.z; f[3] += xv * wa.w; f[4] += xv * wb.x; f[5] += xv * wb.y; f[6] += xv * wb.z; f[7] += xv * wb.w; } }
            float mine = 0.f;
#pragma unroll
            for (int h = 0; h < 8; ++h) { const float s = wave_sum(f[h]); if (lane == h) mine = s; }
            if (lane < 8) { const float z = mine + b_forget[lane]; const float lf = fminf(z, 0.f) - log1pf(expf(-fabsf(z)));
                const int b = m / SEQ, s = m % SEQ; LOGF[((size_t)(b * NHA + lane)) * SEQ + s] = lf; }
        }
    }
    grid.sync();
    if constexpr ((PMASK & 2) != 0) if (bx < BATCH * NHA) {
        PHASE_IDS();
        LAS float* wt = (LAS float*)L;
        const float* src = LOGF + (size_t)bx * SEQ + tid * 16; float v[16];
#pragma unroll
        for (int j = 0; j < 4; ++j) { const f32x4 t = ((const f32x4*)src)[j]; v[4 * j] = t.x; v[4 * j + 1] = t.y; v[4 * j + 2] = t.z; v[4 * j + 3] = t.w; }
#pragma unroll
        for (int j = 1; j < 16; ++j) v[j] += v[j - 1];
        float incl = v[15];
#pragma unroll
        for (int o = 1; o < 64; o <<= 1) { const float t = __shfl_up(incl, o); if (lane >= o) incl += t; }
        if (lane == 63) wt[wave] = incl;
        __syncthreads();
        float off = incl - v[15];
        for (int w = 0; w < wave; ++w) off += wt[w];
        float* dst = KBIAS + (size_t)bx * SEQ + tid * 16;
#pragma unroll
        for (int j = 0; j < 4; ++j) { f32x4 t; t.x = -(v[4 * j] + off) * 1.4426950408889634f; t.y = -(v[4 * j + 1] + off) * 1.4426950408889634f; t.z = -(v[4 * j + 2] + off) * 1.4426950408889634f; t.w = -(v[4 * j + 3] + off) * 1.4426950408889634f; ((f32x4*)dst)[j] = t; }
        __syncthreads();
    }
    if constexpr ((PMASK & 2) != 0) {
        pg8::Gemm g{XN, WIN_t, M, NQKV, DM_}; pg8::StaticOrder S; S.init(M, NQKV, G, bx);
        pg8::EpiBf16<0> E{QKV, 512, nullptr, 512, (size_t)M * 512, attn_body::C2};
        pg8::gemm_phase<pg8::EpiBf16<0>, pg8::StaticOrder, PG8_ALIGN, PG8_SP2>(L, g, S, E);
    }
    grid.sync();
    if constexpr ((PMASK & 4) != 0) {
        const size_t st = (size_t)M * 512;
        const attn_body::AttnTensors AT{(const attn_body::bf16*)QKV, (const attn_body::bf16*)(QKV + st), (const attn_body::bf16*)(QKV + 2 * st),
                                        (const attn_body::bf16*)(QKV + 3 * st), (const attn_body::bf16*)(QKV + 4 * st), (const attn_body::bf16*)(QKV + 5 * st),
                                        (attn_body::bf16*)Y, KBIAS, rel_bias};
        const attn_body::StaticOrder S(G, bx);
        attn_body::attn_phase<attn_body::StaticOrder>((char*)lds, AT, S);
    }
    grid.sync();
    if constexpr ((PMASK & 8) != 0) {
        pg8::Gemm g{Y, WO_t, M, DM_, DM_}; pg8::StaticOrder S; S.init(M, DM_, G, bx);
        pg8::EpiResF32 E{x, out, DM_, ALPHA};
        pg8::gemm_phase<pg8::EpiResF32, pg8::StaticOrder, PG8_ALIGN, PG8_SP2>(L, g, S, E);
    }
    grid.sync();
    { PHASE_IDS(); for (int m = gw; m < M; m += NGW) ln_row(out + (size_t)m * DM_, out + (size_t)m * DM_, XN + (size_t)m * DM_, ln1_g, ln1_b, lane); }
    grid.sync();
    if constexpr ((PMASK & 16) != 0) {
        pg8::Gemm g{XN, WUP_t, M, NUP, DM_}; pg8::StaticOrder S; S.init(M, NUP, G, bx);
        pg8::EpiConvGate E{GB, DFF, conv_w, conv_b, SB, (LAS float*)(L + EX_OFF)};
        pg8::gemm_phase<pg8::EpiConvGate, pg8::StaticOrder, PG8_ALIGN, PG8_SP2>(L, g, S, E);
    }
    grid.sync();
    if constexpr ((PMASK & 32) != 0) {
        PHASE_IDS();
        pg8::StaticOrder S; S.init(M, DM_, G, bx); pg8::Unit u;
        for (int i = 0; S.next(i, u); ++i) {
            if ((u.pm & 31) == 0) continue;
            const float* s0 = SB + (size_t)(u.pm - 1) * 4 * NUP; const float* s1 = SB + (size_t)u.pm * 4 * NUP;
            for (int idx = tid; idx < 2 * DFF; idx += NWAVES * 64) { const int j = idx / DFF, c = idx % DFF;
                float cv[2];
#pragma unroll
                for (int q = 0; q < 2; ++q) { const int gc = q * DFF + c;
                    const float um2 = (j == 0) ? s0[2 * NUP + gc] : s0[3 * NUP + gc], um1 = (j == 0) ? s0[3 * NUP + gc] : s1[gc], u0 = (j == 0) ? s1[gc] : s1[NUP + gc];
                    cv[q] = conv_b[gc] + conv_w[2 * NUP + gc] * u0 + conv_w[NUP + gc] * um1 + conv_w[gc] * um2; }
                GB[((size_t)u.pm * 256 + j) * DFF + c] = (bf16)f2bf(pg8::gelu_tanh_mul(cv[0], cv[1])); }
        }
        asm volatile("s_waitcnt vmcnt(0)" ::: "memory");
        __syncthreads();
        pg8::Gemm g{GB, WDN_t, M, DM_, DFF};
        pg8::EpiResF32 E{out, out, DM_, ALPHA};
        pg8::gemm_phase<pg8::EpiResF32, pg8::StaticOrder, PG8_ALIGN, PG8_SP2>(L, g, S, E);
    }
    grid.sync();
    { PHASE_IDS(); for (int m = gw; m < M; m += NGW) ln_row(out + (size_t)m * DM_, out + (size_t)m * DM_, nullptr, ln2_g, ln2_b, lane); }
}

extern "C" void kernel_launch(void* const* d_in, const int* in_sizes, int n_in, void* d_out, int out_size, void* d_ws, size_t ws_size, hipStream_t stream) {
    static int grid = 0;
    if (grid == 0) {
        int dev = 0, cus = 0, per_cu = 0;
        (void)hipGetDevice(&dev); (void)hipDeviceGetAttribute(&cus, hipDeviceAttributeMultiprocessorCount, dev);
        (void)hipFuncSetAttribute((const void*)mega_fwd, hipFuncAttributeMaxDynamicSharedMemorySize, LDS_BYTES);
        (void)hipOccupancyMaxActiveBlocksPerMultiprocessor(&per_cu, (const void*)mega_fwd, NWAVES * 64, LDS_BYTES);
        if (per_cu < 1) per_cu = 1;
        grid = cus;
        if (ws_size < WS_END) fprintf(stderr, "kernel_launch: workspace too small: %zu < %zu\n", ws_size, (size_t)WS_END);
        (void)hipGetLastError();
    }
    Args a{};
    for (int i = 0; i < 13; ++i) a.in[i] = (const float*)d_in[i];
    a.out = (float*)d_out; a.ws = (unsigned char*)d_ws;
    void* kargs[] = {&a};
    hipError_t e = hipLaunchCooperativeKernel((const void*)mega_fwd, dim3(grid), dim3(NWAVES * 64), kargs, LDS_BYTES, stream);
    if (e != hipSuccess) fprintf(stderr, "cooperative launch failed: %s (grid %d)\n", hipGetErrorString(e), grid);
}
```
